# Optimizing an MI355X kernel written in HIP

```python
import jax, jax.numpy as jnp
from jax import lax
import numpy as np

D_MODEL = 1024
BATCH = 8
SEQ = 2048
DEPTH = 2

N_META = 16
BLOCK = 128
META_PAD = BLOCK - N_META
HEAD_DIM = 64
ROPE_THETA = 10000.0
NORM_EPS = 1e-6
NEG_INF = -1e30
SWA_HEADS = D_MODEL // (2 * HEAD_DIM)
SWA_KV_HEADS = SWA_HEADS // 4
SWA_GROUP = SWA_HEADS // SWA_KV_HEADS
SWA_WINDOW = 128
SWA_WIDTH = SWA_HEADS * HEAD_DIM
SWA_KV_WIDTH = SWA_KV_HEADS * HEAD_DIM
CONV_CHANNELS = D_MODEL // 2
CONV_WIDTH = 31
CONV_LN_EPS = 1e-5
SB_HEADS = D_MODEL // HEAD_DIM
SB_WIDTH = SB_HEADS * HEAD_DIM
AB_SPLITS = (SWA_WIDTH, SWA_KV_WIDTH, SWA_KV_WIDTH, SWA_WIDTH, 2 * CONV_CHANNELS, CONV_CHANNELS)
AB_IN = sum(AB_SPLITS)
AB_MIX = SWA_WIDTH + CONV_CHANNELS
SB_SPLITS = (SB_WIDTH, SB_WIDTH, SB_WIDTH, SB_WIDTH)
SB_IN = sum(SB_SPLITS)
N_EVEN = (DEPTH + 1) // 2
N_ODD = DEPTH // 2

kernel_name = "hybrid_swa_conformer_stickbreaking_trunk"


def _split(x, sizes):
    idx = [int(i) for i in np.cumsum(sizes)[:-1]]
    return jnp.split(x, idx, axis=-1)


def rms_norm(x, g):
    xf = x.astype(jnp.float32)
    y = xf * lax.rsqrt(jnp.mean(xf * xf, axis=-1, keepdims=True) + NORM_EPS)
    return (y * g.astype(jnp.float32)).astype(x.dtype)


def layer_norm(x, g, b):
    xf = x.astype(jnp.float32)
    mu = jnp.mean(xf, axis=-1, keepdims=True)
    xc = xf - mu
    y = xc * lax.rsqrt(jnp.mean(xc * xc, axis=-1, keepdims=True) + CONV_LN_EPS)
    return (y * g.astype(jnp.float32) + b.astype(jnp.float32)).astype(x.dtype)


def apply_rope(x, pos):
    half = x.shape[-1] // 2
    inv = ROPE_THETA ** (-jnp.arange(half, dtype=jnp.float32) / half)
    ang = pos.astype(jnp.float32)[:, None] * inv[None, :]
    cos = jnp.cos(ang)[None, :, None, :]
    sin = jnp.sin(ang)[None, :, None, :]
    xf = x.astype(jnp.float32)
    x1, x2 = xf[..., :half], xf[..., half:]
    return jnp.concatenate([x1 * cos - x2 * sin, x2 * cos + x1 * sin], axis=-1).astype(x.dtype)


def sliding_window_sink_attention(q, k, v, sinks):
    b, l = q.shape[0], q.shape[1]
    lp = l + META_PAD
    nb = lp // BLOCK
    padw = ((0, 0), (META_PAD, 0), (0, 0), (0, 0))
    qb = jnp.pad(q, padw).reshape(b, nb, BLOCK, SWA_KV_HEADS, SWA_GROUP, HEAD_DIM)
    kb = jnp.pad(k, padw).reshape(b, nb, BLOCK, SWA_KV_HEADS, HEAD_DIM)
    vb = jnp.pad(v, padw).reshape(b, nb, BLOCK, SWA_KV_HEADS, HEAD_DIM)

    def band(t):
        prev = jnp.concatenate([jnp.zeros_like(t[:, :1]), t[:, :-1]], axis=1)
        meta = jnp.broadcast_to(t[:, :1], t.shape)
        return jnp.concatenate([meta, prev, t], axis=2)

    kk, vv = band(kb), band(vb)
    scale = HEAD_DIM ** -0.5
    s = jnp.einsum('bnqgrd,bnkgd->bngrqk', qb, kk).astype(jnp.float32) * scale
    blk = jnp.arange(nb)[:, None, None]
    r = jnp.arange(BLOCK)
    qpos = blk * BLOCK + r[None, :, None]
    mpos = r[None, None, :]
    bpos = (blk - 1) * BLOCK + jnp.arange(2 * BLOCK)[None, None, :]
    meta_ok = (mpos >= META_PAD) & (qpos - mpos >= SWA_WINDOW)
    band_ok = (bpos >= META_PAD) & (qpos >= bpos) & (qpos - bpos < SWA_WINDOW)
    mask = jnp.concatenate([jnp.broadcast_to(meta_ok, (nb, BLOCK, BLOCK)), band_ok], axis=-1)
    s = jnp.where(mask[None, :, None, None], s, NEG_INF)
    sink = jnp.broadcast_to(sinks.astype(jnp.float32).reshape(1, 1, SWA_KV_HEADS, SWA_GROUP, 1, 1),
                            s.shape[:-1] + (1,))
    p = jax.nn.softmax(jnp.concatenate([s, sink], axis=-1), axis=-1)[..., :-1]
    o = jnp.einsum('bngrqk,bnkgd->bnqgrd', p.astype(v.dtype), vv)
    return o.reshape(b, lp, SWA_HEADS, HEAD_DIM)[:, META_PAD:]


def causal_depthwise_conv(u, w, bias):
    y = lax.conv_general_dilated(u, w[:, None, :].astype(u.dtype), window_strides=(1,),
                                 padding=((CONV_WIDTH - 1, 0),),
                                 dimension_numbers=('NWC', 'WIO', 'NWC'),
                                 feature_group_count=u.shape[-1])
    return y + bias


def stick_breaking_attention(q, k, v):
    b, l, h, d = q.shape
    lp = l + META_PAD
    nb = lp // BLOCK
    padw = ((0, 0), (META_PAD, 0), (0, 0), (0, 0))
    qp, kp, vp = jnp.pad(q, padw), jnp.pad(k, padw), jnp.pad(v, padw)
    scale = d ** -0.5
    outs = []
    for i in range(nb):
        kend = (i + 1) * BLOCK
        z = jnp.einsum('bqhd,bkhd->bhqk', qp[:, i * BLOCK:kend], kp[:, :kend]).astype(jnp.float32) * scale
        qpos = i * BLOCK + jnp.arange(BLOCK)[:, None]
        kpos = jnp.arange(kend)[None, :]
        valid = (kpos >= META_PAD) & (kpos < qpos)
        log_beta = jax.nn.log_sigmoid(z)
        log_1m = jnp.where(valid, jax.nn.log_sigmoid(-z), 0.0)
        after = lax.cumsum(log_1m, axis=3, reverse=True) - log_1m
        a = jnp.where(valid, jnp.exp(log_beta + after), 0.0)
        outs.append(jnp.einsum('bhqk,bkhd->bqhd', a.astype(v.dtype), vp[:, :kend]))
    return jnp.concatenate(outs, axis=1)[:, META_PAD:]


def swa_conv_mixer(h, pos, w_in, sinks, conv_w, conv_b, ln_g, ln_b, w_pw2, w_out):
    b, l, _ = h.shape
    q, k, v, g_a, glu_in, g_b = _split(h @ w_in, AB_SPLITS)
    q = apply_rope(q.reshape(b, l, SWA_HEADS, HEAD_DIM), pos)
    k = apply_rope(k.reshape(b, l, SWA_KV_HEADS, HEAD_DIM), pos)
    v = v.reshape(b, l, SWA_KV_HEADS, HEAD_DIM)
    a = sliding_window_sink_attention(q, k, v, sinks).reshape(b, l, SWA_WIDTH) * jax.nn.silu(g_a)
    u = glu_in[..., :CONV_CHANNELS] * jax.nn.sigmoid(glu_in[..., CONV_CHANNELS:])
    c = jax.nn.silu(layer_norm(causal_depthwise_conv(u, conv_w, conv_b), ln_g, ln_b))
    c = (c @ w_pw2) * jax.nn.silu(g_b)
    return jnp.concatenate([a, c], axis=-1) @ w_out


def stick_breaking_mixer(h, w_in, w_out):
    b, l, _ = h.shape
    q, k, v, g = _split(h @ w_in, SB_SPLITS)
    shp = (b, l, SB_HEADS, HEAD_DIM)
    o = stick_breaking_attention(q.reshape(shp), k.reshape(shp), v.reshape(shp))
    return (o.reshape(b, l, SB_WIDTH) * jax.nn.silu(g)) @ w_out


def setup_inputs(seed: int = 0) -> dict:
    key = jax.random.key(seed)
    ks = jax.random.split(key, 16)
    f32 = jnp.float32
    nrm = lambda k, s: jax.random.normal(k, s, dtype=f32)
    return {
        "x": nrm(ks[0], (BATCH, SEQ, D_MODEL)),
        "meta_tokens": nrm(ks[1], (N_META, D_MODEL)),
        "ab_pre_norm": 1.0 + 0.05 * nrm(ks[2], (N_EVEN, D_MODEL)),
        "ab_w_in": nrm(ks[3], (N_EVEN, D_MODEL, AB_IN)) * D_MODEL ** -0.5,
        "ab_sinks": nrm(ks[4], (N_EVEN, SWA_HEADS)),
        "ab_conv_w": nrm(ks[5], (N_EVEN, CONV_WIDTH, CONV_CHANNELS)) * CONV_WIDTH ** -0.5,
        "ab_conv_b": 0.02 * nrm(ks[6], (N_EVEN, CONV_CHANNELS)),
        "ab_conv_ln_g": 1.0 + 0.05 * nrm(ks[7], (N_EVEN, CONV_CHANNELS)),
        "ab_conv_ln_b": 0.02 * nrm(ks[8], (N_EVEN, CONV_CHANNELS)),
        "ab_w_pw2": nrm(ks[9], (N_EVEN, CONV_CHANNELS, CONV_CHANNELS)) * CONV_CHANNELS ** -0.5,
        "ab_w_out": nrm(ks[10], (N_EVEN, AB_MIX, D_MODEL)) * AB_MIX ** -0.5,
        "ab_post_norm": 1.0 + 0.05 * nrm(ks[11], (N_EVEN, D_MODEL)),
        "sb_pre_norm": 1.0 + 0.05 * nrm(ks[12], (N_ODD, D_MODEL)),
        "sb_w_in": nrm(ks[13], (N_ODD, D_MODEL, SB_IN)) * D_MODEL ** -0.5,
        "sb_w_out": nrm(ks[14], (N_ODD, SB_WIDTH, D_MODEL)) * SB_WIDTH ** -0.5,
        "sb_post_norm": 1.0 + 0.05 * nrm(ks[15], (N_ODD, D_MODEL)),
    }


def reference(x, meta_tokens, ab_pre_norm, ab_w_in, ab_sinks, ab_conv_w, ab_conv_b, ab_conv_ln_g,
              ab_conv_ln_b, ab_w_pw2, ab_w_out, ab_post_norm, sb_pre_norm, sb_w_in, sb_w_out,
              sb_post_norm):
    b = x.shape[0]
    meta = jnp.broadcast_to(meta_tokens[None].astype(x.dtype), (b, N_META, D_MODEL))
    h = jnp.concatenate([meta, x], axis=1)
    pos = jnp.arange(h.shape[1])
    for layer in range(DEPTH):
        i = layer // 2
        if layer % 2 == 0:
            y = swa_conv_mixer(rms_norm(h, ab_pre_norm[i]), pos, ab_w_in[i], ab_sinks[i],
                               ab_conv_w[i], ab_conv_b[i], ab_conv_ln_g[i], ab_conv_ln_b[i],
                               ab_w_pw2[i], ab_w_out[i])
            h = h + rms_norm(y, ab_post_norm[i])
        else:
            y = stick_breaking_mixer(rms_norm(h, sb_pre_norm[i]), sb_w_in[i], sb_w_out[i])
            h = h + rms_norm(y, sb_post_norm[i])
    return h[:, N_META:]
```

```cpp
#include <hip/hip_runtime.h>
#include <cstdint>
#include <cstdio>

typedef unsigned short bf16;
typedef short bf16x8 __attribute__((ext_vector_type(8)));
typedef float f32x4 __attribute__((ext_vector_type(4)));
typedef unsigned u32x4 __attribute__((ext_vector_type(4)));
typedef unsigned u32x2 __attribute__((ext_vector_type(2)));

constexpr int NB = 8, SEQ = 2048, DM = 1024, NMETA = 16, LT = SEQ + NMETA  , M = NB * SEQ  ;
constexpr int N_IN0 = 2816, N_IN1 = 4096, CC = 512  , CW = 31;
constexpr float LOG2E = 1.4426950408889634f;
constexpr float QSCALE = 0.125f * LOG2E;
constexpr float NORM_EPS = 1e-6f, LN_EPS = 1e-5f;

constexpr size_t MiB = 1u << 20;
constexpr size_t WS_CTL = 0;
constexpr size_t WS_ROPE = 1 * MiB;
constexpr size_t WS_META = 2 * MiB;
constexpr size_t WS_WIN0 = 4 * MiB, WS_WPW2 = 10 * MiB, WS_WOUT0 = 11 * MiB, WS_WIN1 = 13 * MiB, WS_WOUT1 = 21 * MiB;
constexpr size_t WS_XN = 24 * MiB;
constexpr size_t WS_Q0 = 56 * MiB, WS_K0 = 73 * MiB, WS_V0 = 78 * MiB, WS_GA = 83 * MiB, WS_U = 100 * MiB, WS_GB = 117 * MiB;
constexpr size_t WS_CACT = 134 * MiB;
constexpr size_t WS_AC = 150 * MiB;
constexpr size_t WS_Q1 = 56 * MiB, WS_K1 = 89 * MiB, WS_V1 = 122 * MiB;
constexpr size_t WS_G1 = 155 * MiB;
constexpr size_t WS_O1 = 187 * MiB;
constexpr size_t WS_Y0 = 187 * MiB;
constexpr size_t WS_Y1 = 56 * MiB;
constexpr size_t WS_END = 256 * MiB;

__device__ const double INVF[32] = {1.0, 0.7498942093324559, 0.5623413251903491, 0.4216965034285822, 0.31622776601683794, 0.23713737056616552, 0.1778279410038923, 0.1333521432163324, 0.1, 0.07498942093324558, 0.05623413251903491, 0.042169650342858224, 0.03162277660168379, 0.023713737056616554, 0.01778279410038923, 0.01333521432163324, 0.01, 0.007498942093324558, 0.005623413251903491, 0.004216965034285823, 0.0031622776601683794, 0.0023713737056616554, 0.0017782794100389228, 0.001333521432163324, 0.001, 0.0007498942093324559, 0.0005623413251903491, 0.00042169650342858224, 0.00031622776601683794, 0.00023713737056616554, 0.00017782794100389227, 0.0001333521432163324};

__device__ __forceinline__ unsigned f2bf(float f) { unsigned u = __builtin_bit_cast(unsigned, f); return (u + 0x7fffu + ((u >> 16) & 1u)) >> 16; }
__device__ __forceinline__ unsigned pk2(float lo, float hi) { return f2bf(lo) | (f2bf(hi) << 16); }
__device__ __forceinline__ float bf2f(bf16 h) { return __builtin_bit_cast(float, (unsigned)h << 16); }
__device__ __forceinline__ float sigmoid_(float x) { return __builtin_amdgcn_rcpf(1.f + __builtin_amdgcn_exp2f(-x * LOG2E)); }
__device__ __forceinline__ float silu_(float x) { return x * sigmoid_(x); }
__device__ __forceinline__ float wave_sum(float v) {
#pragma unroll
    for (int o = 1; o < 64; o <<= 1) v += __shfl_xor(v, o);
    return v;
}
__device__ __forceinline__ void store4(bf16* p, float a, float b, float c, float d) { u32x2 w; w.x = pk2(a, b); w.y = pk2(c, d); *(u32x2*)p = w; }
__device__ __forceinline__ void store2(bf16* p, float a, float b) { *(unsigned*)p = pk2(a, b); }
__device__ __forceinline__ void load8(const bf16* p, float* o) { const u32x4 w = *(const u32x4*)p;
    o[0] = __builtin_bit_cast(float, w.x << 16); o[1] = __builtin_bit_cast(float, w.x & 0xffff0000u); o[2] = __builtin_bit_cast(float, w.y << 16); o[3] = __builtin_bit_cast(float, w.y & 0xffff0000u);
    o[4] = __builtin_bit_cast(float, w.z << 16); o[5] = __builtin_bit_cast(float, w.z & 0xffff0000u); o[6] = __builtin_bit_cast(float, w.w << 16); o[7] = __builtin_bit_cast(float, w.w & 0xffff0000u); }

__device__ __forceinline__ int src_col(int mode, int np) {
    if (mode != 1) return np;
    if (np < 640) { const int base = np & ~63, p = np & 63; return base + (p >> 1) + 32 * (p & 1); }
    if (np < 1280) return np;
    if (np < 2304) { const int e = np - 1280; return 1280 + (e >> 1) + 512 * (e & 1); }
    return np;
}
__device__ __forceinline__ float col_scale(int mode, int np) { return (mode == 1 && np < 512) || (mode == 2 && np < 1024) ? QSCALE : 1.f; }
template <class SCR>
__device__ __forceinline__ void wconv_item(const float* W, int K, int N, bf16* WT, SCR scr, int item, int lane, int mode, const float* g) {
    const int nblk = N / 32, kb = item / nblk, nb = item % nblk, k0 = 64 * kb, n0 = 32 * nb;
    const int sc = src_col(mode, n0 + (lane & 31)); const float cs = col_scale(mode, n0 + (lane & 31));
#pragma unroll 8
    for (int i = 0; i < 32; ++i) { const int kk = 2 * i + (lane >> 5); float v = W[(size_t)(k0 + kk) * N + sc] * cs; if (g) v *= g[k0 + kk]; scr[kk * 33 + (lane & 31)] = v; }
    asm volatile("s_waitcnt lgkmcnt(0)" ::: "memory");
    const int c = lane & 7;
#pragma unroll
    for (int j = 0; j < 4; ++j) { const int n = (lane >> 3) + 8 * j; auto s = scr + (8 * c) * 33 + n;
        u32x4 o; o.x = pk2(s[0 * 33], s[1 * 33]); o.y = pk2(s[2 * 33], s[3 * 33]); o.z = pk2(s[4 * 33], s[5 * 33]); o.w = pk2(s[6 * 33], s[7 * 33]);
        *(u32x4*)(WT + (size_t)(n0 + n) * K + k0 + 8 * c) = o; }
    asm volatile("s_waitcnt lgkmcnt(0)" ::: "memory");
}
__global__ void __launch_bounds__(256) k_wconv(const float* W, int K, int N, bf16* WT, int mode, const float* g) {
    __shared__ float scr_all[4][64 * 33];
    const int wave = threadIdx.x >> 6, lane = threadIdx.x & 63; float* scr = scr_all[wave];
    const int nitems = (K / 64) * (N / 32);
    for (int it = blockIdx.x * 4 + wave; it < nitems; it += gridDim.x * 4) wconv_item(W, K, N, WT, scr, it, lane, mode, g);
}
__device__ __forceinline__ void rope_entry(int idx, float* cosT, float* sinT) {
    const int pos = idx >> 5, j = idx & 31;
    const double rev = (double)pos * INVF[j] * 0.15915494309189535; const double fr = rev - floor(rev);
    cosT[idx] = __builtin_amdgcn_cosf((float)fr); sinT[idx] = __builtin_amdgcn_sinf((float)fr);
}
__global__ void k_rope(float* cosT, float* sinT) { const int idx = blockIdx.x * blockDim.x + threadIdx.x; if (idx < LT * 32) rope_entry(idx, cosT, sinT); }

__device__ __forceinline__ void rms_row_to_bf16(const float* xrow, bf16* orow, int lane) {
    const f32x4* xr = (const f32x4*)xrow + lane; f32x4 v[4]; float s = 0.f;
#pragma unroll
    for (int j = 0; j < 4; ++j) { v[j] = xr[64 * j]; s += (v[j].x * v[j].x + v[j].y * v[j].y) + (v[j].z * v[j].z + v[j].w * v[j].w); }
    const float rstd = 1.f / sqrtf(wave_sum(s) * (1.f / DM) + NORM_EPS);
    unsigned long long* o8 = (unsigned long long*)orow + lane;
#pragma unroll
    for (int j = 0; j < 4; ++j) o8[64 * j] = (unsigned long long)pk2(v[j].x * rstd, v[j].y * rstd) | ((unsigned long long)pk2(v[j].z * rstd, v[j].w * rstd) << 32);
}
__global__ void __launch_bounds__(256) k_rms_rows(const float* x, bf16* xn, int rows) {
    const int r = blockIdx.x * 4 + (threadIdx.x >> 6); if (r < rows) rms_row_to_bf16(x + (size_t)r * DM, xn + (size_t)r * DM, threadIdx.x & 63);
}

template <int MT, int NT, class Epi>
__device__ __forceinline__ void wave_gemm(const bf16* A, const bf16* Bt, int K, int m0, int n0, const Epi& epi) {
    const int lane = threadIdx.x & 63, fr = lane & 15, fq = lane >> 4;
    f32x4 acc[MT][NT];
#pragma unroll
    for (int i = 0; i < MT; ++i)
#pragma unroll
        for (int j = 0; j < NT; ++j) acc[i][j] = (f32x4){0.f, 0.f, 0.f, 0.f};
    for (int k0 = 0; k0 < K; k0 += 32) {
        bf16x8 a[MT], b[NT];
#pragma unroll
        for (int i = 0; i < MT; ++i) a[i] = *(const bf16x8*)(A + (size_t)(m0 + 16 * i + fr) * K + k0 + 8 * fq);
#pragma unroll
        for (int j = 0; j < NT; ++j) b[j] = *(const bf16x8*)(Bt + (size_t)(n0 + 16 * j + fr) * K + k0 + 8 * fq);
#pragma unroll
        for (int i = 0; i < MT; ++i)
#pragma unroll
            for (int j = 0; j < NT; ++j) acc[i][j] = __builtin_amdgcn_mfma_f32_16x16x32_bf16(b[j], a[i], acc[i][j], 0, 0, 0);
    }
#pragma unroll
    for (int i = 0; i < MT; ++i)
#pragma unroll
        for (int j = 0; j < NT; ++j) epi(m0 + 16 * i + fr, n0 + 16 * j + 4 * fq, acc[i][j]);
}
template <int MT, class Epi>
__global__ void __launch_bounds__(256) k_gemm(const bf16* A, const bf16* Bt, int K, int nbase, Epi epi) {
    const int wave = threadIdx.x >> 6;
    wave_gemm<MT, 4>(A, Bt, K, (int)blockIdx.y * 16 * MT, nbase + ((int)blockIdx.x * 4 + wave) * 64, epi);
}

template <bool META> struct EpiIn0 {
    bf16 *Q0, *K0, *V0, *GA, *U, *GB; const float *cosT, *sinT;
    __device__ __forceinline__ void operator()(int m, int n, f32x4 v) const {
        int pos, R; if (META) { pos = m; R = m; } else { const int b = m >> 11, t = m & 2047; pos = NMETA + t; R = b * LT + NMETA + t; }
        bf16* dst; int pitch; float o0, o1, o2 = 0.f, o3 = 0.f; bool two = false;
        if (n < 640) {
            const int jp = (n & 63) >> 1; const float c0 = cosT[pos * 32 + jp], s0 = sinT[pos * 32 + jp], c1 = cosT[pos * 32 + jp + 1], s1 = sinT[pos * 32 + jp + 1];
            o0 = v[0] * c0 - v[1] * s0; o1 = v[1] * c0 + v[0] * s0; o2 = v[2] * c1 - v[3] * s1; o3 = v[3] * c1 + v[2] * s1;
            if (n < 512) { dst = Q0 + n; pitch = 512; } else { dst = K0 + (n - 512); pitch = 128; }
        } else if (n < 768) { dst = V0 + (n - 640); pitch = 128; o0 = v[0]; o1 = v[1]; o2 = v[2]; o3 = v[3]; }
        else if (n < 1280) { dst = GA + (n - 768); pitch = 512; o0 = silu_(v[0]); o1 = silu_(v[1]); o2 = silu_(v[2]); o3 = silu_(v[3]); }
        else if (n < 2304) { dst = U + ((n - 1280) >> 1); pitch = 512; o0 = v[0] * sigmoid_(v[1]); o1 = v[2] * sigmoid_(v[3]); two = true; }
        else { dst = GB + (n - 2304); pitch = 512; o0 = silu_(v[0]); o1 = silu_(v[1]); o2 = silu_(v[2]); o3 = silu_(v[3]); }
        if (META) {
#pragma unroll
            for (int b = 0; b < NB; ++b) { bf16* p = dst + (size_t)(b * LT + R) * pitch; if (two) store2(p, o0, o1); else store4(p, o0, o1, o2, o3); }
        } else { bf16* p = dst + (size_t)R * pitch; if (two) store2(p, o0, o1); else store4(p, o0, o1, o2, o3); }
    }
};
template <bool META> struct EpiPw2 {
    const bf16* GB; bf16* AC;
    __device__ __forceinline__ void operator()(int m, int n, f32x4 v) const {
        int R; if (META) R = m; else { const int b = m >> 11, t = m & 2047; R = b * LT + NMETA + t; }
        const u32x2 g = *(const u32x2*)(GB + (size_t)R * 512 + n);
        store4(AC + (size_t)m * DM + 512 + n, v[0] * __builtin_bit_cast(float, g.x << 16), v[1] * __builtin_bit_cast(float, g.x & 0xffff0000u),
               v[2] * __builtin_bit_cast(float, g.y << 16), v[3] * __builtin_bit_cast(float, g.y & 0xffff0000u));
    }
};
struct EpiF32 { float* Y; __device__ __forceinline__ void operator()(int m, int n, f32x4 v) const { *(f32x4*)(Y + (size_t)m * DM + n) = v; } };
template <bool META> struct EpiIn1 {
    bf16 *Q1, *K1, *V1, *G1;
    __device__ __forceinline__ void operator()(int m, int n, f32x4 v) const {
        if (META) {
            bf16* dst = (n < 2048 ? K1 + (n - 1024) : V1 + (n - 2048));
#pragma unroll
            for (int b = 0; b < NB; ++b) store4(dst + (size_t)(b * LT + m) * DM, v[0], v[1], v[2], v[3]);
        } else {
            const int b = m >> 11, t = m & 2047; const size_t R = (size_t)b * LT + NMETA + t;
            if (n < 1024) store4(Q1 + R * DM + n, v[0], v[1], v[2], v[3]);
            else if (n < 2048) store4(K1 + R * DM + (n - 1024), v[0], v[1], v[2], v[3]);
            else if (n < 3072) store4(V1 + R * DM + (n - 2048), v[0], v[1], v[2], v[3]);
            else store4(G1 + (size_t)m * DM + (n - 3072), silu_(v[0]), silu_(v[1]), silu_(v[2]), silu_(v[3]));
        }
    }
};

__global__ void __launch_bounds__(512) k_conv_naive(const bf16* U, const float* cw, const float* cb, const float* lg, const float* lb, bf16* CACT, bf16* CACTm) {
    __shared__ float red[8];
    const int c = threadIdx.x, wave = c >> 6; int b, i; bf16* out;
    if (blockIdx.x < M) { const int m = blockIdx.x; b = m >> 11; i = NMETA + (m & 2047); out = CACT + (size_t)m * CC; } else { b = 0; i = blockIdx.x - M; out = CACTm + (size_t)i * CC; }
    float acc = cb[c];
    for (int w = 0; w < CW; ++w) { const int j = i - (CW - 1) + w; if (j >= 0) acc += cw[w * CC + c] * bf2f(U[(size_t)(b * LT + j) * CC + c]); }
    float s = wave_sum(acc); if ((c & 63) == 0) red[wave] = s; __syncthreads();
    float tot = 0.f; for (int k = 0; k < 8; ++k) tot += red[k]; const float mean = tot * (1.f / CC); __syncthreads();
    const float d = acc - mean; s = wave_sum(d * d); if ((c & 63) == 0) red[wave] = s; __syncthreads();
    tot = 0.f; for (int k = 0; k < 8; ++k) tot += red[k];
    const float y = d * (1.f / sqrtf(tot * (1.f / CC) + LN_EPS)) * lg[c] + lb[c];
    out[c] = (bf16)f2bf(silu_(y));
}
__global__ void __launch_bounds__(64) k_swa_naive(const bf16* Q0, const bf16* K0, const bf16* V0, const bf16* GA, const float* sinks, bf16* AC, bf16* ACm) {
    const int tile = blockIdx.x % 33, bh = blockIdx.x / 33, h = bh & 7, b = bh >> 3, i = tile * 64 + threadIdx.x;
    if (i >= LT || (i < NMETA && b > 0)) return;
    const size_t R = (size_t)b * LT + i; const int g = h >> 2;
    float q[64], o[64];
#pragma unroll
    for (int c = 0; c < 8; ++c) load8(Q0 + R * 512 + h * 64 + 8 * c, q + 8 * c);
#pragma unroll
    for (int d = 0; d < 64; ++d) o[d] = 0.f;
    float mx = sinks[h] * LOG2E, l = 1.f;
    const int jlo = i - 127 > 0 ? i - 127 : 0;
    const int nmeta = jlo < NMETA ? jlo : NMETA;
    const int nk = (i - jlo + 1) + nmeta;
    for (int kk = 0; kk < nk; ++kk) {
        const int j = kk < nmeta ? kk : jlo + (kk - nmeta);
        const bf16* kr = K0 + ((size_t)b * LT + j) * 128 + g * 64; const bf16* vr = V0 + ((size_t)b * LT + j) * 128 + g * 64;
        float kf[8], s = 0.f;
#pragma unroll
        for (int c = 0; c < 8; ++c) { load8(kr + 8 * c, kf);
#pragma unroll
            for (int e = 0; e < 8; ++e) s += q[8 * c + e] * kf[e]; }
        const float mn = fmaxf(mx, s), f = __builtin_amdgcn_exp2f(mx - mn), p = __builtin_amdgcn_exp2f(s - mn);
        l = l * f + p; mx = mn;
#pragma unroll
        for (int c = 0; c < 8; ++c) { load8(vr + 8 * c, kf);
#pragma unroll
            for (int e = 0; e < 8; ++e) o[8 * c + e] = o[8 * c + e] * f + p * kf[e]; }
    }
    const float rl = 1.f / l;
    bf16* out = (i < NMETA) ? ACm + (size_t)i * DM + h * 64 : AC + ((size_t)b * SEQ + (i - NMETA)) * DM + h * 64;
#pragma unroll
    for (int c = 0; c < 8; ++c) { float ga[8]; load8(GA + R * 512 + h * 64 + 8 * c, ga);
        store4(out + 8 * c, o[8 * c] * rl * ga[0], o[8 * c + 1] * rl * ga[1], o[8 * c + 2] * rl * ga[2], o[8 * c + 3] * rl * ga[3]);
        store4(out + 8 * c + 4, o[8 * c + 4] * rl * ga[4], o[8 * c + 5] * rl * ga[5], o[8 * c + 6] * rl * ga[6], o[8 * c + 7] * rl * ga[7]); }
}
__global__ void __launch_bounds__(256) k_post0(const float* Y, const float* h0, const float* gp, float* h1, bf16* XN, int rows) {
    const int r = blockIdx.x * 4 + (threadIdx.x >> 6), lane = threadIdx.x & 63; if (r >= rows) return;
    const f32x4* yr = (const f32x4*)(Y + (size_t)r * DM) + lane; const f32x4* hr = (const f32x4*)(h0 + (size_t)r * DM) + lane; const f32x4* gr = (const f32x4*)gp + lane;
    f32x4 v[4]; float s = 0.f;
#pragma unroll
    for (int j = 0; j < 4; ++j) { v[j] = yr[64 * j]; s += (v[j].x * v[j].x + v[j].y * v[j].y) + (v[j].z * v[j].z + v[j].w * v[j].w); }
    const float rstd = 1.f / sqrtf(wave_sum(s) * (1.f / DM) + NORM_EPS); s = 0.f;
#pragma unroll
    for (int j = 0; j < 4; ++j) { v[j] = hr[64 * j] + v[j] * rstd * gr[64 * j]; s += (v[j].x * v[j].x + v[j].y * v[j].y) + (v[j].z * v[j].z + v[j].w * v[j].w); }
    if (h1) {
#pragma unroll
        for (int j = 0; j < 4; ++j) ((f32x4*)(h1 + (size_t)r * DM) + lane)[64 * j] = v[j]; }
    const float rstd2 = 1.f / sqrtf(wave_sum(s) * (1.f / DM) + NORM_EPS);
    unsigned long long* o8 = (unsigned long long*)(XN + (size_t)r * DM) + lane;
#pragma unroll
    for (int j = 0; j < 4; ++j) o8[64 * j] = (unsigned long long)pk2(v[j].x * rstd2, v[j].y * rstd2) | ((unsigned long long)pk2(v[j].z * rstd2, v[j].w * rstd2) << 32);
}
__global__ void __launch_bounds__(256) k_post1(const float* Y, const float* gp, float* out, int rows) {
    const int r = blockIdx.x * 4 + (threadIdx.x >> 6), lane = threadIdx.x & 63; if (r >= rows) return;
    const f32x4* yr = (const f32x4*)(Y + (size_t)r * DM) + lane; f32x4* orow = (f32x4*)(out + (size_t)r * DM) + lane; const f32x4* gr = (const f32x4*)gp + lane;
    f32x4 v[4]; float s = 0.f;
#pragma unroll
    for (int j = 0; j < 4; ++j) { v[j] = yr[64 * j]; s += (v[j].x * v[j].x + v[j].y * v[j].y) + (v[j].z * v[j].z + v[j].w * v[j].w); }
    const float rstd = 1.f / sqrtf(wave_sum(s) * (1.f / DM) + NORM_EPS);
#pragma unroll
    for (int j = 0; j < 4; ++j) orow[64 * j] = orow[64 * j] + v[j] * rstd * gr[64 * j];
}
__global__ void __launch_bounds__(64) k_sb_naive(const bf16* Q1, const bf16* K1, const bf16* V1, const bf16* G1, bf16* O1) {
    const int qt = blockIdx.x & 31, bh = blockIdx.x >> 5, h = bh & 15, b = bh >> 4, lane = threadIdx.x, t = qt * 64 + lane, i = NMETA + t;
    float q[64], o[64];
#pragma unroll
    for (int c = 0; c < 8; ++c) load8(Q1 + ((size_t)b * LT + i) * DM + h * 64 + 8 * c, q + 8 * c);
#pragma unroll
    for (int d = 0; d < 64; ++d) o[d] = 0.f;
    float Rs = 0.f;
    for (int j = NMETA + qt * 64 + 62; j >= 0; --j) {
        const bf16* kr = K1 + ((size_t)b * LT + j) * DM + h * 64; const bf16* vr = V1 + ((size_t)b * LT + j) * DM + h * 64;
        float kf[8], z = 0.f;
#pragma unroll
        for (int c = 0; c < 8; ++c) { load8(kr + 8 * c, kf);
#pragma unroll
            for (int e = 0; e < 8; ++e) z += q[8 * c + e] * kf[e]; }
        const bool valid = j < i;
        const float sp = fmaxf(z, 0.f) + __builtin_amdgcn_logf(1.f + __builtin_amdgcn_exp2f(-fabsf(z)));
        const float a = valid ? __builtin_amdgcn_exp2f((z - sp) + Rs) : 0.f;
        Rs += valid ? -sp : 0.f;
#pragma unroll
        for (int c = 0; c < 8; ++c) { load8(vr + 8 * c, kf);
#pragma unroll
            for (int e = 0; e < 8; ++e) o[8 * c + e] += a * kf[e]; }
    }
    const size_t m = (size_t)b * SEQ + t;
#pragma unroll
    for (int c = 0; c < 8; ++c) { float ga[8]; load8(G1 + m * DM + h * 64 + 8 * c, ga); bf16* out = O1 + m * DM + h * 64 + 8 * c;
        store4(out, o[8 * c] * ga[0], o[8 * c + 1] * ga[1], o[8 * c + 2] * ga[2], o[8 * c + 3] * ga[3]);
        store4(out + 4, o[8 * c + 4] * ga[4], o[8 * c + 5] * ga[5], o[8 * c + 6] * ga[6], o[8 * c + 7] * ga[7]); }
}

extern "C" void kernel_launch(void* const* d_in, const int* in_sizes, int n_in, void* d_out, int out_size, void* d_ws, size_t ws_size, hipStream_t stream) {
    if (n_in != 16 || in_sizes[0] != M * DM || out_size != M * DM || ws_size < WS_END) { fprintf(stderr, "kernel_launch: unexpected shapes\n"); return; }
    const float* x = (const float*)d_in[0]; const float* meta = (const float*)d_in[1]; const float* ab_pre = (const float*)d_in[2]; const float* ab_win = (const float*)d_in[3];
    const float* sinks = (const float*)d_in[4]; const float* convw = (const float*)d_in[5]; const float* convb = (const float*)d_in[6]; const float* lng = (const float*)d_in[7];
    const float* lnb = (const float*)d_in[8]; const float* wpw2 = (const float*)d_in[9]; const float* wout0 = (const float*)d_in[10]; const float* ab_post = (const float*)d_in[11];
    const float* sb_pre = (const float*)d_in[12]; const float* sb_win = (const float*)d_in[13]; const float* sb_wout = (const float*)d_in[14]; const float* sb_post = (const float*)d_in[15];
    unsigned char* ws = (unsigned char*)d_ws; float* out = (float*)d_out;
    float* cosT = (float*)(ws + WS_ROPE); float* sinT = cosT + LT * 32;
    bf16* XNm = (bf16*)(ws + WS_META); bf16* ACm = XNm + 16 * DM; bf16* CACTm = ACm + 16 * DM; float* Ym = (float*)(CACTm + 16 * CC);
    bf16 *Win0 = (bf16*)(ws + WS_WIN0), *Wpw2 = (bf16*)(ws + WS_WPW2), *Wout0 = (bf16*)(ws + WS_WOUT0), *Win1 = (bf16*)(ws + WS_WIN1), *Wout1 = (bf16*)(ws + WS_WOUT1);
    bf16* XN = (bf16*)(ws + WS_XN);
    bf16 *Q0 = (bf16*)(ws + WS_Q0), *K0 = (bf16*)(ws + WS_K0), *V0 = (bf16*)(ws + WS_V0), *GA = (bf16*)(ws + WS_GA), *U = (bf16*)(ws + WS_U), *GB = (bf16*)(ws + WS_GB);
    bf16 *CACT = (bf16*)(ws + WS_CACT), *AC = (bf16*)(ws + WS_AC);
    bf16 *Q1 = (bf16*)(ws + WS_Q1), *K1 = (bf16*)(ws + WS_K1), *V1 = (bf16*)(ws + WS_V1), *G1 = (bf16*)(ws + WS_G1), *O1 = (bf16*)(ws + WS_O1);
    float* Y0 = (float*)(ws + WS_Y0); float* Y1 = (float*)(ws + WS_Y1);

    k_wconv<<<512, 256, 0, stream>>>(ab_win, DM, N_IN0, Win0, 1, ab_pre);
    k_wconv<<<128, 256, 0, stream>>>(wpw2, CC, CC, Wpw2, 0, nullptr);
    k_wconv<<<256, 256, 0, stream>>>(wout0, DM, DM, Wout0, 0, nullptr);
    k_wconv<<<512, 256, 0, stream>>>(sb_win, DM, N_IN1, Win1, 2, sb_pre);
    k_wconv<<<256, 256, 0, stream>>>(sb_wout, DM, DM, Wout1, 0, nullptr);
    k_rope<<<(LT * 32 + 255) / 256, 256, 0, stream>>>(cosT, sinT);
    k_rms_rows<<<M / 4, 256, 0, stream>>>(x, XN, M);
    k_rms_rows<<<4, 256, 0, stream>>>(meta, XNm, 16);
    { EpiIn0<false> e{Q0, K0, V0, GA, U, GB, cosT, sinT}; k_gemm<4, EpiIn0<false>><<<dim3(N_IN0 / 256, M / 64), 256, 0, stream>>>(XN, Win0, DM, 0, e);
      EpiIn0<true> em{Q0, K0, V0, GA, U, GB, cosT, sinT}; k_gemm<1, EpiIn0<true>><<<dim3(N_IN0 / 256, 1), 256, 0, stream>>>(XNm, Win0, DM, 0, em); }
    k_conv_naive<<<M + 16, 512, 0, stream>>>(U, convw, convb, lng, lnb, CACT, CACTm);
    { EpiPw2<false> e{GB, AC}; k_gemm<4, EpiPw2<false>><<<dim3(CC / 256, M / 64), 256, 0, stream>>>(CACT, Wpw2, CC, 0, e);
      EpiPw2<true> em{GB, ACm}; k_gemm<1, EpiPw2<true>><<<dim3(CC / 256, 1), 256, 0, stream>>>(CACTm, Wpw2, CC, 0, em); }
    k_swa_naive<<<NB * 8 * 33, 64, 0, stream>>>(Q0, K0, V0, GA, sinks, AC, ACm);
    { EpiF32 e{Y0}; k_gemm<4, EpiF32><<<dim3(DM / 256, M / 64), 256, 0, stream>>>(AC, Wout0, DM, 0, e);
      EpiF32 em{Ym}; k_gemm<1, EpiF32><<<dim3(DM / 256, 1), 256, 0, stream>>>(ACm, Wout0, DM, 0, em); }
    k_post0<<<M / 4, 256, 0, stream>>>(Y0, x, ab_post, out, XN, M);
    k_post0<<<4, 256, 0, stream>>>(Ym, meta, ab_post, nullptr, XNm, 16);
    { EpiIn1<false> e{Q1, K1, V1, G1}; k_gemm<4, EpiIn1<false>><<<dim3(N_IN1 / 256, M / 64), 256, 0, stream>>>(XN, Win1, DM, 0, e);
      EpiIn1<true> em{Q1, K1, V1, G1}; k_gemm<1, EpiIn1<true>><<<dim3(2048 / 256, 1), 256, 0, stream>>>(XNm, Win1, DM, 1024, em); }
    k_sb_naive<<<NB * 16 * 32, 64, 0, stream>>>(Q1, K1, V1, G1, O1);
    { EpiF32 e{Y1}; k_gemm<4, EpiF32><<<dim3(DM / 256, M / 64), 256, 0, stream>>>(O1, Wout1, DM, 0, e); }
    k_post1<<<M / 4, 256, 0, stream>>>(Y1, sb_post, out, M);
}
```
